# Optimizing an MI355X kernel written in HIP

```python
import math
import jax, jax.numpy as jnp
from jax import lax
import numpy as np

D_MODEL = 1024
BATCH = 2
SEQ = 8192
DEPTH = 4

GRID_W = 64
ROPE_THETA = 10000.0
Q_BLOCK = 128
EPS = 1e-6

GQA_HEADS = 8
GQA_KV_HEADS = 2
GQA_GROUP = GQA_HEADS // GQA_KV_HEADS
GQA_HEAD_DIM = D_MODEL // 16
GQA_Q_W = GQA_HEADS * GQA_HEAD_DIM
GQA_KV_W = GQA_KV_HEADS * GQA_HEAD_DIM

MLA_HEADS = 8
MLA_NOPE_DIM = D_MODEL // 16
MLA_ROPE_DIM = D_MODEL // 32
MLA_V_DIM = D_MODEL // 16
MLA_QK_DIM = MLA_NOPE_DIM + MLA_ROPE_DIM
MLA_Q_RANK = (3 * D_MODEL) // 8
MLA_KV_RANK = D_MODEL // 4
MLA_OUT_W = MLA_HEADS * MLA_V_DIM

D_FF = 4 * D_MODEL

SPLIT_SIZES = (GQA_Q_W, GQA_KV_W, GQA_KV_W, MLA_Q_RANK, MLA_KV_RANK, MLA_ROPE_DIM, 2 * D_MODEL)
IN_W = sum(SPLIT_SIZES)
SPLIT_POINTS = [int(v) for v in np.cumsum(SPLIT_SIZES)[:-1]]

kernel_name = "hybrid_gqa_mla_sandwich_encoder"


def rmsnorm(x, g):
    xf = x.astype(jnp.float32)
    y = xf * lax.rsqrt(jnp.mean(xf * xf, axis=-1, keepdims=True) + EPS)
    return (y * g.astype(jnp.float32)).astype(x.dtype)


def axial_rope_tables(seq, rot_dim):
    rows = seq // GRID_W
    row = jnp.repeat(jnp.arange(rows, dtype=jnp.float32), GRID_W)
    col = jnp.tile(jnp.arange(GRID_W, dtype=jnp.float32), rows)
    half = rot_dim // 2
    inv = ROPE_THETA ** (-jnp.arange(0, half, 2, dtype=jnp.float32) / half)
    ar = row[:, None] * inv[None, :]
    ac = col[:, None] * inv[None, :]
    ang = jnp.concatenate([ar, ar, ac, ac], axis=-1)
    return jnp.cos(ang), jnp.sin(ang)


def apply_axial_rope(x, cos, sin):
    d = x.shape[-1]
    h = d // 2
    q = h // 2
    shape = (cos.shape[0],) + (1,) * (x.ndim - 3) + (d,)
    c = cos.reshape(shape).astype(x.dtype)
    s = sin.reshape(shape).astype(x.dtype)
    xr, xc = x[..., :h], x[..., h:]
    rot = lambda z: jnp.concatenate([-z[..., q:], z[..., :q]], axis=-1)
    x_rot = jnp.concatenate([rot(xr), rot(xc)], axis=-1)
    return x * c + x_rot * s


def blocked_attention(q, k, v, scale):
    b, s, hk, g, dk = q.shape
    dv = v.shape[-1]
    nb = s // Q_BLOCK
    qb = q.reshape(b, nb, Q_BLOCK, hk, g, dk).swapaxes(0, 1)

    def one_block(qblk):
        sc = jnp.einsum('bqhgd,bkhd->bhgqk', qblk, k).astype(jnp.float32) * scale
        p = jax.nn.softmax(sc, axis=-1).astype(v.dtype)
        return jnp.einsum('bhgqk,bkhd->bqhgd', p, v)

    out = lax.map(one_block, qb)
    return out.swapaxes(0, 1).reshape(b, s, hk * g * dv)


def token_mixer(u, w_in, b_gate, q_norm_g, k_norm_g, q_a_norm_g, kv_a_norm_g,
                w_q_up, w_kv_up, w_branch_a, w_branch_b, w_o,
                cos_a, sin_a, cos_b, sin_b):
    b, s, _ = u.shape
    z = u @ w_in
    qa, ka, va, cq, ckv, kr, gl = jnp.split(z, SPLIT_POINTS, axis=-1)

    qa = qa.reshape(b, s, GQA_HEADS, GQA_HEAD_DIM)
    ka = ka.reshape(b, s, GQA_KV_HEADS, GQA_HEAD_DIM)
    va = va.reshape(b, s, GQA_KV_HEADS, GQA_HEAD_DIM)
    qa = apply_axial_rope(rmsnorm(qa, q_norm_g), cos_a, sin_a)
    ka = apply_axial_rope(rmsnorm(ka, k_norm_g), cos_a, sin_a)
    qa = qa.reshape(b, s, GQA_KV_HEADS, GQA_GROUP, GQA_HEAD_DIM)
    ya = blocked_attention(qa, ka, va, 1.0 / math.sqrt(GQA_HEAD_DIM))

    qb = (rmsnorm(cq, q_a_norm_g) @ w_q_up).reshape(b, s, MLA_HEADS, MLA_QK_DIM)
    q_nope, q_rope = qb[..., :MLA_NOPE_DIM], qb[..., MLA_NOPE_DIM:]
    q_rope = apply_axial_rope(q_rope, cos_b, sin_b)
    kvb = (rmsnorm(ckv, kv_a_norm_g) @ w_kv_up).reshape(b, s, MLA_HEADS, MLA_NOPE_DIM + MLA_V_DIM)
    k_nope, vb = kvb[..., :MLA_NOPE_DIM], kvb[..., MLA_NOPE_DIM:]
    k_rope = apply_axial_rope(kr, cos_b, sin_b)
    k_rope = jnp.broadcast_to(k_rope[:, :, None, :], (b, s, MLA_HEADS, MLA_ROPE_DIM))
    qb = jnp.concatenate([q_nope, q_rope], axis=-1)[:, :, :, None, :]
    kb = jnp.concatenate([k_nope, k_rope], axis=-1)
    yb = blocked_attention(qb, kb, vb, 1.0 / math.sqrt(MLA_QK_DIM))

    gates = jax.nn.sigmoid((gl + b_gate).astype(jnp.float32)).astype(u.dtype)
    g_a, g_b = gates[..., :D_MODEL], gates[..., D_MODEL:]
    merged = g_a * (ya @ w_branch_a) + g_b * (yb @ w_branch_b)
    return merged @ w_o


def setup_inputs(seed: int = 0) -> dict:
    key = jax.random.key(seed)
    ks = jax.random.split(key, 20)
    f32 = jnp.float32

    def w(k, fan_in, fan_out):
        return jax.random.normal(k, (DEPTH, fan_in, fan_out), f32) * fan_in ** -0.5

    def gain(k, n):
        return 1.0 + 0.05 * jax.random.normal(k, (DEPTH, n), f32)

    return {
        "x": jax.random.normal(ks[0], (BATCH, SEQ, D_MODEL), f32),
        "w_in": w(ks[1], D_MODEL, IN_W),
        "b_gate": 0.1 * jax.random.normal(ks[2], (DEPTH, 2 * D_MODEL), f32),
        "q_norm_g": gain(ks[3], GQA_HEAD_DIM),
        "k_norm_g": gain(ks[4], GQA_HEAD_DIM),
        "q_a_norm_g": gain(ks[5], MLA_Q_RANK),
        "kv_a_norm_g": gain(ks[6], MLA_KV_RANK),
        "w_q_up": w(ks[7], MLA_Q_RANK, MLA_HEADS * MLA_QK_DIM),
        "w_kv_up": w(ks[8], MLA_KV_RANK, MLA_HEADS * (MLA_NOPE_DIM + MLA_V_DIM)),
        "w_branch_a": w(ks[9], GQA_Q_W, D_MODEL),
        "w_branch_b": w(ks[10], MLA_OUT_W, D_MODEL),
        "w_o": w(ks[11], D_MODEL, D_MODEL),
        "w_ffn_up": w(ks[12], D_MODEL, D_FF),
        "w_ffn_down": w(ks[13], D_FF, D_MODEL),
        "pre_mix_g": gain(ks[14], D_MODEL),
        "post_mix_g": gain(ks[15], D_MODEL),
        "pre_ffn_g": gain(ks[16], D_MODEL),
        "post_ffn_g": gain(ks[17], D_MODEL),
    }


def reference(x, w_in, b_gate, q_norm_g, k_norm_g, q_a_norm_g, kv_a_norm_g,
              w_q_up, w_kv_up, w_branch_a, w_branch_b, w_o, w_ffn_up, w_ffn_down,
              pre_mix_g, post_mix_g, pre_ffn_g, post_ffn_g):
    seq = x.shape[1]
    cos_a, sin_a = axial_rope_tables(seq, GQA_HEAD_DIM)
    cos_b, sin_b = axial_rope_tables(seq, MLA_ROPE_DIM)
    for l in range(DEPTH):
        u = rmsnorm(x, pre_mix_g[l])
        m = token_mixer(u, w_in[l], b_gate[l], q_norm_g[l], k_norm_g[l],
                        q_a_norm_g[l], kv_a_norm_g[l], w_q_up[l], w_kv_up[l],
                        w_branch_a[l], w_branch_b[l], w_o[l],
                        cos_a, sin_a, cos_b, sin_b)
        x = x + rmsnorm(m, post_mix_g[l])
        h = rmsnorm(x, pre_ffn_g[l]) @ w_ffn_up[l]
        f = jnp.square(jax.nn.relu(h)) @ w_ffn_down[l]
        x = x + rmsnorm(f, post_ffn_g[l])
    return x
```

```cpp
#include <hip/hip_runtime.h>
#include <hip/hip_cooperative_groups.h>
#include <cstdio>
#include <cstdint>
namespace cg = cooperative_groups;

#ifndef PH_MASK
#define PH_MASK 0x3ff
#endif
#ifndef MK_ONE_LAUNCH
#define MK_ONE_LAUNCH 0
#endif

#define LAS __attribute__((address_space(3)))
typedef unsigned short bf16_t;
typedef short bf16x8 __attribute__((ext_vector_type(8)));
typedef short s16x4 __attribute__((ext_vector_type(4)));
typedef float f32x4 __attribute__((ext_vector_type(4)));
typedef float f32x16 __attribute__((ext_vector_type(16)));
typedef unsigned u32x4 __attribute__((ext_vector_type(4)));
typedef unsigned u32x2 __attribute__((ext_vector_type(2)));

constexpr int M = 16384, DM = 1024, SEQ = 8192, FF = 4096, DEPTH = 4;
constexpr int INW = 3488, NIN = 3584;
constexpr float EPS = 1e-6f;

constexpr size_t MiB = 1u << 20;
constexpr size_t SM_RSTD = 0;
constexpr size_t SM_SLQ = 64 * 1024;
constexpr size_t SM_SLKV = SM_SLQ + 512 * 1024;
constexpr size_t SM_SLM = SM_SLKV + 256 * 1024;
constexpr size_t SM_TABA = SM_SLM + 1024 * 1024;
constexpr size_t SM_TABB = SM_TABA + 16384;
constexpr size_t WS_W = 3 * MiB;
constexpr size_t W_IN = 0, W_Q = W_IN + (size_t)NIN * 1024 * 2, W_KV = W_Q + 768 * 384 * 2, W_A = W_KV + 1024 * 256 * 2,
                 W_B = W_A + 1024 * 512 * 2, W_O = W_B + 1024 * 512 * 2, W_UP = W_O + 1024 * 1024 * 2, W_DN = W_UP + (size_t)4096 * 1024 * 2,
                 W_END = W_DN + (size_t)1024 * 4096 * 2;
static_assert(WS_W + W_END <= 32 * MiB, "weights");
constexpr size_t WS_XB = 32 * MiB;
constexpr size_t WS_G = 64 * MiB;
constexpr size_t WS_B = 128 * MiB;
constexpr size_t B_QA = 0, B_KA = 16 * MiB, B_VA = 20 * MiB, B_CQ = 24 * MiB, B_CKV = 36 * MiB, B_QB = 44 * MiB, B_KB = 68 * MiB, B_VB = 92 * MiB;
constexpr size_t B_T = 0, B_MG = 68 * MiB, B_H = 0;
constexpr size_t WS_END = 256 * MiB;

constexpr int LDS_BYTES = 131072 + 1024;

__device__ __forceinline__ unsigned cvt_pk_bf16(float lo, float hi) { unsigned r; asm volatile("v_cvt_pk_bf16_f32 %0, %1, %2" : "=v"(r) : "v"(lo), "v"(hi)); return r; }
__device__ __forceinline__ void st_bf4(bf16_t* p, f32x4 v) { u32x2 w; w.x = cvt_pk_bf16(v[0], v[1]); w.y = cvt_pk_bf16(v[2], v[3]); *(u32x2*)p = w; }
__device__ __forceinline__ f32x4 ld_bf4(const bf16_t* p) { const u32x2 w = *(const u32x2*)p; f32x4 r; r[0] = __uint_as_float(w.x << 16); r[1] = __uint_as_float(w.x & 0xffff0000u); r[2] = __uint_as_float(w.y << 16); r[3] = __uint_as_float(w.y & 0xffff0000u); return r; }
__device__ __forceinline__ float sumsq4(f32x4 v) { return (v[0] * v[0] + v[1] * v[1]) + (v[2] * v[2] + v[3] * v[3]); }
__device__ __forceinline__ float wave_sum(float v) {
#pragma unroll
    for (int o = 1; o < 64; o <<= 1) v += __shfl_xor(v, o);
    return v;
}

namespace pg8 {
#define PG8_LAS __attribute__((address_space(3)))
constexpr int BM = 256, BK = 64, HALF = 128, HTB = HALF * BK * 2, STAGE_BYTES = 8 * HTB, NXCD = 8, WGM = 8;
__host__ __device__ __forceinline__ int lds_byte(int r, int c) { const int st = (r >> 4) * 2 + (c >> 5), rr = r & 15, cc = c & 31, ob = rr * 64 + cc * 2; return st * 1024 + (ob ^ (((ob >> 9) & 1) << 5)); }
__host__ __device__ __forceinline__ void stage_rc(int b, int& R, int& C) { const int st = b / 1024, sb = b % 1024, swz = sb ^ (((sb >> 9) & 1) << 5); R = (st >> 1) * 16 + swz / 64; C = (st & 1) * 32 + (swz % 64) / 2; }
__host__ __device__ __forceinline__ int perm32(int rho) { const int n = rho >> 4, i = rho & 15; return 8 * (i >> 2) + 4 * n + (i & 3); }

struct Unit { int pm, pn; };
struct Gemm { const bf16_t* A; const bf16_t* Bt; int M, N, K, lda, ldb; };

struct StaticOrder {
    int nM, nN, nwg, G, c;
    __host__ __device__ void init(int M_, int N_, int G_, int c_) { nM = M_ / BM; nN = N_ / BM; nwg = nM * nN; G = G_; c = c_; }
    __host__ __device__ bool next(int i, Unit& u) const {
        const long L = (long)i * G + c; if (L >= nwg) return false;
        int wgid = (int)L; { const int q = nwg / NXCD, r = nwg % NXCD, xcd = wgid % NXCD, off = wgid / NXCD; wgid = (xcd < r ? xcd * (q + 1) : r * (q + 1) + (xcd - r) * q) + off; }
        const int nig = WGM * nN, gid = wgid / nig, fm = gid * WGM, gsz = (nM - fm) < WGM ? (nM - fm) : WGM;
        u.pm = fm + ((wgid % nig) % gsz); u.pn = (wgid % nig) / gsz; return true;
    }
};

template <class Epi, bool ALIGN_EPI = false>
__device__ __forceinline__ void gemm_phase(PG8_LAS unsigned char* lds, const Gemm g, const StaticOrder& S, const Epi& E, const int tid) {
    const int wid = __builtin_amdgcn_readfirstlane(tid >> 6), lane = tid & 63, wr = wid >> 2, wc = wid & 3, fr = lane & 15, fq = lane >> 4;
    const int K = g.K, nt = K / BK;
    unsigned voffA[2], voffB[2];
#pragma unroll
    for (int i = 0; i < 2; ++i) { int R, C; stage_rc(tid * 16 + i * 8192, R, C); const int Rb = Epi::PERM ? ((R & ~31) + perm32(R & 31)) : R;
        voffA[i] = (unsigned)(R * g.lda + C) * 2u; voffB[i] = (unsigned)(Rb * g.ldb + C) * 2u; }
    const size_t kstep = (size_t)(BK * 2);
    const size_t hstepA = (size_t)HALF * g.lda * 2, hstepB = (size_t)HALF * g.ldb * 2;
    const size_t tstepA = 2 * hstepA, tstepB = 2 * hstepB;
    const unsigned ldsw = (unsigned)wid * 1024u;
    const int aoff = lds_byte(wr * 64 + fr, fq * 8), boff = lds_byte(wc * 32 + fr, fq * 8);
#define PG8_SA(b, h) (((b) * 2 + (h)) * HTB)
#define PG8_SB(b, h) ((4 + (b) * 2 + (h)) * HTB)
#define PG8_STAGE(bufoff, gbase, voff) do { _Pragma("unroll") for (int _i = 0; _i < 2; ++_i) \
        __builtin_amdgcn_global_load_lds((const unsigned*)((const char*)(gbase) + (voff)[_i]), (PG8_LAS unsigned*)(lds + (bufoff) + ldsw + _i * 8192), 16, 0, 0); } while (0)
#define PG8_LDA(dst, b, h) do { _Pragma("unroll") for (int m = 0; m < 4; ++m) _Pragma("unroll") for (int k = 0; k < 2; ++k) dst[m][k] = *(const PG8_LAS bf16x8*)(lds + PG8_SA(b, h) + aoff + m * 2048 + k * 1024); } while (0)
#define PG8_LDB(dst, b, h) do { _Pragma("unroll") for (int n = 0; n < 2; ++n) _Pragma("unroll") for (int k = 0; k < 2; ++k) dst[n][k] = *(const PG8_LAS bf16x8*)(lds + PG8_SB(b, h) + boff + n * 2048 + k * 1024); } while (0)
#define PG8_MMA(ai, bj, At, Bt) do { __builtin_amdgcn_s_setprio(1); _Pragma("unroll") for (int m = 0; m < 4; ++m) _Pragma("unroll") for (int n = 0; n < 2; ++n) _Pragma("unroll") for (int k = 0; k < 2; ++k) \
        acc[ai][bj][m][n] = __builtin_amdgcn_mfma_f32_16x16x32_bf16(Bt[n][k], At[m][k], acc[ai][bj][m][n], 0, 0, 0); __builtin_amdgcn_s_setprio(0); } while (0)
#define PG8_WAIT_V(n) asm volatile("s_waitcnt vmcnt(" #n ")" ::: "memory")
#define PG8_WAIT_L(n) asm volatile("s_waitcnt lgkmcnt(" #n ")" ::: "memory")
#define PG8_BAR __builtin_amdgcn_s_barrier()
#define PG8_SCHED __builtin_amdgcn_sched_barrier(0)
    Unit cur, nxt; int ui = 0;
    if (!S.next(0, cur)) return;
    f32x4 acc[2][2][4][2];
#pragma unroll
    for (int a = 0; a < 2; ++a)
#pragma unroll
        for (int b = 0; b < 2; ++b)
#pragma unroll
            for (int m = 0; m < 4; ++m)
#pragma unroll
                for (int n = 0; n < 2; ++n) acc[a][b][m][n] = (f32x4){0.f, 0.f, 0.f, 0.f};
    bf16x8 At[4][2], B0[2][2], B1[2][2];
    const char* cA = (const char*)g.A + (size_t)cur.pm * tstepA; const char* cB = (const char*)g.Bt + (size_t)cur.pn * tstepB;
    PG8_STAGE(PG8_SB(0, 0), cB, voffB); PG8_STAGE(PG8_SB(0, 1), cB + hstepB, voffB); PG8_STAGE(PG8_SA(0, 0), cA, voffA); PG8_STAGE(PG8_SA(0, 1), cA + hstepA, voffA);
    if (wr == 1) PG8_BAR;
    PG8_WAIT_V(2); PG8_BAR;
    PG8_STAGE(PG8_SB(1, 0), cB + kstep, voffB); PG8_STAGE(PG8_SA(1, 0), cA + kstep, voffA); PG8_STAGE(PG8_SB(1, 1), cB + hstepB + kstep, voffB);
    PG8_WAIT_V(6); PG8_BAR;
    for (;;) {
        const bool has_next = S.next(ui + 1, nxt);
        const char* nA = has_next ? (const char*)g.A + (size_t)nxt.pm * tstepA : cA; const char* nB = has_next ? (const char*)g.Bt + (size_t)nxt.pn * tstepB : cB;
#pragma unroll 1
        for (int t = 0; t < nt; t += 2) {
            const bool last = (t == nt - 2);
            const char* a1 = cA + (size_t)(t + 1) * kstep;
            const char* a2 = last ? nA : cA + (size_t)(t + 2) * kstep; const char* b2 = last ? nB : cB + (size_t)(t + 2) * kstep;
            const char* a3 = a2 + kstep; const char* b3 = b2 + kstep;
            PG8_LDB(B0, 0, 0); PG8_LDB(B1, 0, 1); PG8_SCHED; PG8_LDA(At, 0, 0); PG8_STAGE(PG8_SA(1, 1), a1 + hstepA, voffA);
            PG8_WAIT_V(8); PG8_WAIT_L(0); PG8_BAR; PG8_MMA(0, 0, At, B0); PG8_MMA(0, 1, At, B1); PG8_BAR; PG8_SCHED;
            PG8_LDA(At, 0, 1); PG8_STAGE(PG8_SB(0, 0), b2, voffB); PG8_STAGE(PG8_SB(0, 1), b2 + hstepB, voffB); PG8_STAGE(PG8_SA(0, 0), a2, voffA);
            PG8_WAIT_V(8); PG8_WAIT_L(0); PG8_BAR; PG8_MMA(1, 0, At, B0); PG8_MMA(1, 1, At, B1); PG8_BAR; PG8_SCHED;
            PG8_LDB(B0, 1, 0); PG8_LDB(B1, 1, 1); PG8_SCHED; PG8_LDA(At, 1, 0); PG8_STAGE(PG8_SA(0, 1), a2 + hstepA, voffA);
            PG8_WAIT_V(8); PG8_WAIT_L(0); PG8_BAR; PG8_MMA(0, 0, At, B0); PG8_MMA(0, 1, At, B1); PG8_BAR; PG8_SCHED;
            PG8_LDA(At, 1, 1); PG8_STAGE(PG8_SB(1, 0), b3, voffB); PG8_STAGE(PG8_SB(1, 1), b3 + hstepB, voffB); PG8_STAGE(PG8_SA(1, 0), a3, voffA);
            PG8_WAIT_V(8); PG8_WAIT_L(0); PG8_BAR; PG8_MMA(1, 0, At, B0); PG8_MMA(1, 1, At, B1); PG8_BAR; PG8_SCHED;
        }
        if constexpr (ALIGN_EPI) { if (wr == 0) PG8_BAR; }
        E(acc, cur, wr, wc, fr, fq);
        if (!has_next) break;
#pragma unroll
        for (int a = 0; a < 2; ++a)
#pragma unroll
            for (int b = 0; b < 2; ++b)
#pragma unroll
                for (int m = 0; m < 4; ++m)
#pragma unroll
                    for (int n = 0; n < 2; ++n) acc[a][b][m][n] = (f32x4){0.f, 0.f, 0.f, 0.f};
        cur = nxt; cA = nA; cB = nB; ++ui;
        if constexpr (ALIGN_EPI) { if (wr == 1) PG8_BAR; }
    }
    PG8_WAIT_V(0);
    if constexpr (!ALIGN_EPI) { if (wr == 0) PG8_BAR; }
    PG8_BAR;
#undef PG8_SA
#undef PG8_SB
#undef PG8_STAGE
#undef PG8_LDA
#undef PG8_LDB
#undef PG8_MMA
#undef PG8_WAIT_V
#undef PG8_WAIT_L
#undef PG8_BAR
#undef PG8_SCHED
}
}
using pg8::Unit;

typedef const f32x4 (&AccRef)[2][2][4][2];

struct EpiIn {
    static constexpr bool PERM = false;
    const float* rstdx; const float* qg; const float* kg; const float* bgate; const float* tabA; const float* tabB;
    bf16_t *Qa, *Ka, *Va, *Cq, *Ckv, *Kb, *G; float *slq, *slkv;
    __device__ __forceinline__ void operator()(AccRef acc, const Unit& u, int wr, int wc, int fr, int fq) const {
        const int pn = u.pn;
#pragma unroll
        for (int ai = 0; ai < 2; ++ai)
#pragma unroll
            for (int m = 0; m < 4; ++m) {
                asm volatile("" ::: "memory");
                int row = u.pm * 256 + ai * 128 + wr * 64 + m * 16 + fr; asm volatile("" : "+v"(row));
                const float rs = rstdx[row];
                const int s = row & (SEQ - 1), gr = s >> 6, gc = s & 63;
                f32x4 v[2][2];
#pragma unroll
                for (int bj = 0; bj < 2; ++bj)
#pragma unroll
                    for (int n = 0; n < 2; ++n) v[bj][n] = acc[ai][bj][m][n] * rs;
                if (pn < 3) {
                    const bool plain = (pn == 2 && wc >= 2);
                    if (!plain) {
                        float ss = (sumsq4(v[0][0]) + sumsq4(v[0][1])) + (sumsq4(v[1][0]) + sumsq4(v[1][1]));
                        ss += __shfl_xor(ss, 16); ss += __shfl_xor(ss, 32);
                        const float hr = rsqrtf(ss * (1.0f / 64.0f) + EPS);
                        const float* gp = (pn < 2) ? qg : kg;
#pragma unroll
                        for (int bj = 0; bj < 2; ++bj) {
                            const int pos = bj ? gc : gr;
                            const f32x4 cs = *(const f32x4*)(tabA + pos * 16 + 4 * fq), sn = *(const f32x4*)(tabA + 2048 + pos * 16 + 4 * fq);
                            const f32x4 g0 = *(const f32x4*)(gp + 32 * bj + 4 * fq), g1 = *(const f32x4*)(gp + 32 * bj + 16 + 4 * fq);
                            const f32x4 a = v[bj][0] * hr * g0, b = v[bj][1] * hr * g1;
                            v[bj][0] = a * cs - b * sn; v[bj][1] = b * cs + a * sn;
                        }
                    }
                    bf16_t* base = (pn < 2) ? Qa + (size_t)row * 512 + (pn * 4 + wc) * 64 : (wc < 2 ? Ka + (size_t)row * 128 + wc * 64 : Va + (size_t)row * 128 + (wc - 2) * 64);
#pragma unroll
                    for (int bj = 0; bj < 2; ++bj)
#pragma unroll
                        for (int n = 0; n < 2; ++n) st_bf4(base + 32 * bj + 16 * n + 4 * fq, v[bj][n]);
                } else if (pn == 3) {
                    float ss = (sumsq4(v[0][0]) + sumsq4(v[0][1])) + (sumsq4(v[1][0]) + sumsq4(v[1][1]));
                    ss += __shfl_xor(ss, 16); ss += __shfl_xor(ss, 32);
                    if (fq == 0) slq[row * 8 + wc] = ss;
#pragma unroll
                    for (int bj = 0; bj < 2; ++bj)
#pragma unroll
                        for (int n = 0; n < 2; ++n) st_bf4(Cq + (size_t)row * 384 + 128 * bj + 32 * wc + 16 * n + 4 * fq, v[bj][n]);
                } else if (pn == 4) {
                    float ss = sumsq4(v[0][0]) + sumsq4(v[0][1]);
                    ss += __shfl_xor(ss, 16); ss += __shfl_xor(ss, 32);
                    if (fq == 0) slq[row * 8 + 4 + wc] = ss;
#pragma unroll
                    for (int n = 0; n < 2; ++n) st_bf4(Cq + (size_t)row * 384 + 256 + 32 * wc + 16 * n + 4 * fq, v[0][n]);
                    if (wc == 0) {
                        const int pos = (fq < 2) ? gr : gc;
                        const f32x4 cs = *(const f32x4*)(tabB + pos * 8 + 4 * (fq & 1)), sn = *(const f32x4*)(tabB + 1024 + pos * 8 + 4 * (fq & 1));
                        const f32x4 a = v[1][0], b = v[1][1];
                        const f32x4 oa = a * cs - b * sn, ob = b * cs + a * sn;
                        const int da = (fq < 2) ? 4 * fq : 4 * fq + 8;
#pragma unroll
                        for (int h = 0; h < 8; ++h) { st_bf4(Kb + (size_t)row * 768 + h * 96 + 64 + da, oa); st_bf4(Kb + (size_t)row * 768 + h * 96 + 64 + da + 8, ob); }
                    }
                } else if (pn == 5) {
                    float ss = (sumsq4(v[0][0]) + sumsq4(v[0][1])) + (sumsq4(v[1][0]) + sumsq4(v[1][1]));
                    ss += __shfl_xor(ss, 16); ss += __shfl_xor(ss, 32);
                    if (fq == 0) slkv[row * 4 + wc] = ss;
#pragma unroll
                    for (int bj = 0; bj < 2; ++bj)
#pragma unroll
                        for (int n = 0; n < 2; ++n) st_bf4(Ckv + (size_t)row * 256 + 128 * bj + 32 * wc + 16 * n + 4 * fq, v[bj][n]);
                } else {
#pragma unroll
                    for (int bj = 0; bj < 2; ++bj)
#pragma unroll
                        for (int n = 0; n < 2; ++n) {
                            const int c = (pn - 6) * 256 + 128 * bj + 32 * wc + 16 * n + 4 * fq;
                            const f32x4 x = v[bj][n] + *(const f32x4*)(bgate + c);
                            f32x4 o;
#pragma unroll
                            for (int j = 0; j < 4; ++j) o[j] = 1.0f / (1.0f + __expf(-x[j]));
                            st_bf4(G + (size_t)row * 2048 + c, o);
                        }
                }
            }
    }
};

struct EpiQup {
    static constexpr bool PERM = false;
    const float* slq; const float* tabB; bf16_t* Qb;
    __device__ __forceinline__ void operator()(AccRef acc, const Unit& u, int wr, int wc, int fr, int fq) const {
        const int pn = u.pn;
#pragma unroll
        for (int ai = 0; ai < 2; ++ai)
#pragma unroll
            for (int m = 0; m < 4; ++m) {
                asm volatile("" ::: "memory");
                int row = u.pm * 256 + ai * 128 + wr * 64 + m * 16 + fr; asm volatile("" : "+v"(row));
                const f32x4 s0 = *(const f32x4*)(slq + row * 8), s1 = *(const f32x4*)(slq + row * 8 + 4);
                const float ss = ((s0[0] + s0[1]) + (s0[2] + s0[3])) + ((s1[0] + s1[1]) + (s1[2] + s1[3]));
                const float rq = rsqrtf(ss * (1.0f / 384.0f) + EPS);
                const int s = row & (SEQ - 1), gr = s >> 6, gc = s & 63;
                if (pn < 2) {
#pragma unroll
                    for (int bj = 0; bj < 2; ++bj)
#pragma unroll
                        for (int n = 0; n < 2; ++n) {
                            const int c = pn * 256 + 128 * bj + 32 * wc + 16 * n + 4 * fq;
                            st_bf4(Qb + (size_t)row * 768 + (c >> 6) * 96 + (c & 63), acc[ai][bj][m][n] * rq);
                        }
                } else {
                    const int pos = (fq < 2) ? gr : gc;
                    const f32x4 cs = *(const f32x4*)(tabB + pos * 8 + 4 * (fq & 1)), sn = *(const f32x4*)(tabB + 1024 + pos * 8 + 4 * (fq & 1));
                    const int da = (fq < 2) ? 4 * fq : 4 * fq + 8;
#pragma unroll
                    for (int bj = 0; bj < 2; ++bj) {
                        const f32x4 a = acc[ai][bj][m][0] * rq, b = acc[ai][bj][m][1] * rq;
                        bf16_t* base = Qb + (size_t)row * 768 + (4 * bj + wc) * 96 + 64;
                        st_bf4(base + da, a * cs - b * sn); st_bf4(base + da + 8, b * cs + a * sn);
                    }
                }
            }
    }
};

struct EpiKVup {
    static constexpr bool PERM = false;
    const float* slkv; bf16_t *Kb, *Vb;
    __device__ __forceinline__ void operator()(AccRef acc, const Unit& u, int wr, int wc, int fr, int fq) const {
        const int pn = u.pn;
#pragma unroll
        for (int ai = 0; ai < 2; ++ai)
#pragma unroll
            for (int m = 0; m < 4; ++m) {
                asm volatile("" ::: "memory");
                int row = u.pm * 256 + ai * 128 + wr * 64 + m * 16 + fr; asm volatile("" : "+v"(row));
                const f32x4 s0 = *(const f32x4*)(slkv + row * 4);
                const float rk = rsqrtf(((s0[0] + s0[1]) + (s0[2] + s0[3])) * (1.0f / 256.0f) + EPS);
#pragma unroll
                for (int bj = 0; bj < 2; ++bj)
#pragma unroll
                    for (int n = 0; n < 2; ++n) {
                        const int head = 2 * pn + bj, e = 32 * wc + 16 * n + 4 * fq;
                        bf16_t* p = (wc < 2) ? Kb + (size_t)row * 768 + head * 96 + e : Vb + (size_t)row * 512 + head * 64 + (e - 64);
                        st_bf4(p, acc[ai][bj][m][n] * rk);
                    }
            }
    }
};

template <int MODE> struct EpiBranch {
    static constexpr bool PERM = false;
    const bf16_t* G; float* T; bf16_t* Mg;
    __device__ __forceinline__ void operator()(AccRef acc, const Unit& u, int wr, int wc, int fr, int fq) const {
#pragma unroll
        for (int ai = 0; ai < 2; ++ai)
#pragma unroll
            for (int m = 0; m < 4; ++m) {
                asm volatile("" ::: "memory");
                int row = u.pm * 256 + ai * 128 + wr * 64 + m * 16 + fr; asm volatile("" : "+v"(row));
#pragma unroll
                for (int bj = 0; bj < 2; ++bj)
#pragma unroll
                    for (int n = 0; n < 2; ++n) {
                        const int c = u.pn * 256 + 128 * bj + 32 * wc + 16 * n + 4 * fq;
                        const f32x4 gt = ld_bf4(G + (size_t)row * 2048 + MODE * 1024 + c);
                        if (MODE == 0) *(f32x4*)(T + (size_t)row * 1024 + c) = acc[ai][bj][m][n] * gt;
                        else st_bf4(Mg + (size_t)row * 1024 + c, *(const f32x4*)(T + (size_t)row * 1024 + c) + acc[ai][bj][m][n] * gt);
                    }
            }
    }
};

struct EpiF32Stats {
    static constexpr bool PERM = false;
    float* O; float* slm;
    __device__ __forceinline__ void operator()(AccRef acc, const Unit& u, int wr, int wc, int fr, int fq) const {
#pragma unroll
        for (int ai = 0; ai < 2; ++ai)
#pragma unroll
            for (int m = 0; m < 4; ++m) {
                asm volatile("" ::: "memory");
                int row = u.pm * 256 + ai * 128 + wr * 64 + m * 16 + fr; asm volatile("" : "+v"(row));
                float ss = (sumsq4(acc[ai][0][m][0]) + sumsq4(acc[ai][0][m][1])) + (sumsq4(acc[ai][1][m][0]) + sumsq4(acc[ai][1][m][1]));
                ss += __shfl_xor(ss, 16); ss += __shfl_xor(ss, 32);
                if (fq == 0) slm[row * 16 + u.pn * 4 + wc] = ss;
#pragma unroll
                for (int bj = 0; bj < 2; ++bj)
#pragma unroll
                    for (int n = 0; n < 2; ++n) *(f32x4*)(O + (size_t)row * 1024 + u.pn * 256 + 128 * bj + 32 * wc + 16 * n + 4 * fq) = acc[ai][bj][m][n];
            }
    }
};

struct EpiUp {
    static constexpr bool PERM = true;
    const float* rstdx; bf16_t* H;
    __device__ __forceinline__ void operator()(AccRef acc, const Unit& u, int wr, int wc, int fr, int fq) const {
#pragma unroll
        for (int ai = 0; ai < 2; ++ai)
#pragma unroll
            for (int m = 0; m < 4; ++m) {
                asm volatile("" ::: "memory");
                int row = u.pm * 256 + ai * 128 + wr * 64 + m * 16 + fr; asm volatile("" : "+v"(row));
                const float rs = rstdx[row];
#pragma unroll
                for (int bj = 0; bj < 2; ++bj) {
                    f32x4 v0 = acc[ai][bj][m][0] * rs, v1 = acc[ai][bj][m][1] * rs;
#pragma unroll
                    for (int j = 0; j < 4; ++j) { const float a = fmaxf(v0[j], 0.f), b = fmaxf(v1[j], 0.f); v0[j] = a * a; v1[j] = b * b; }
                    u32x4 w; w.x = cvt_pk_bf16(v0[0], v0[1]); w.y = cvt_pk_bf16(v0[2], v0[3]); w.z = cvt_pk_bf16(v1[0], v1[1]); w.w = cvt_pk_bf16(v1[2], v1[3]);
                    *(u32x4*)(H + (size_t)row * 4096 + u.pn * 256 + 128 * bj + 32 * wc + 8 * fq) = w;
                }
            }
    }
};

namespace att {
#define SBAR() __builtin_amdgcn_sched_barrier(0)
constexpr int SHM_V = 64 * 64 * 2;
constexpr float THR = 8.f;
template <int DK> struct Cfg {
    static constexpr int KROWB = (DK == 64) ? 128 : 256, SHM_K = 64 * KROWB, NK = DK / 16;
    static constexpr float SCALE = (DK == 64) ? 0.125f : 0.10206207261596575f;
    __device__ static __forceinline__ int kswz(int row, int colB) { return (DK == 64) ? row * 128 + (colB ^ (((row >> 1) & 7) << 4)) : row * 256 + (colB ^ ((row & 7) << 4)); }
};
__device__ __forceinline__ int crow(int r, int hi) { return (r & 3) + 8 * (r >> 2) + 4 * hi; }

template <int DK> __device__ __forceinline__ void partialSM(f32x16& p0, f32x16& p1, float& m_reg, float& mn, float& alpha) {
    constexpr float SCALE = Cfg<DK>::SCALE, C = SCALE * 1.4426950408889634f;
    float pmax = p0[0];
#pragma unroll
    for (int r = 1; r < 16; ++r) pmax = fmaxf(pmax, p0[r]);
#pragma unroll
    for (int r = 0; r < 16; ++r) pmax = fmaxf(pmax, p1[r]);
    { auto rr = __builtin_amdgcn_permlane32_swap(__float_as_uint(pmax), __float_as_uint(pmax), false, false);
      pmax = fmaxf(__uint_as_float(rr[0]), __uint_as_float(rr[1])); }
    if (__builtin_expect(__all(pmax - m_reg <= THR / SCALE), 1)) { mn = m_reg; alpha = 1.f; }
    else { mn = fmaxf(m_reg, pmax); alpha = __builtin_amdgcn_exp2f((m_reg - mn) * C); m_reg = mn; }
    const float mnC = -mn * C;
#pragma unroll
    for (int r = 0; r < 16; ++r) p0[r] = fmaf(p0[r], C, mnC);
#pragma unroll
    for (int r = 0; r < 16; ++r) p1[r] = fmaf(p1[r], C, mnC);
#pragma unroll
    for (int r = 0; r < 16; ++r) p0[r] = __builtin_amdgcn_exp2f(p0[r]);
}
__device__ __forceinline__ void finishSM(f32x16& p0, f32x16& p1, float alpha, float& l_reg, bf16x8& pa0, bf16x8& pa1, bf16x8& pa2, bf16x8& pa3) {
#pragma unroll
    for (int r = 0; r < 16; ++r) p1[r] = __builtin_amdgcn_exp2f(p1[r]);
    float ps = 0;
#pragma unroll
    for (int r = 0; r < 16; ++r) ps += p0[r];
#pragma unroll
    for (int r = 0; r < 16; ++r) ps += p1[r];
    { auto rr = __builtin_amdgcn_permlane32_swap(__float_as_uint(ps), __float_as_uint(ps), false, false);
      ps = __uint_as_float(rr[0]) + __uint_as_float(rr[1]); }
    l_reg = l_reg * alpha + ps;
#define PK4(P, BASE, OUT) do { unsigned a0 = cvt_pk_bf16(P[BASE + 0], P[BASE + 1]), a1 = cvt_pk_bf16(P[BASE + 2], P[BASE + 3]);   \
    unsigned b0 = cvt_pk_bf16(P[BASE + 4], P[BASE + 5]), b1 = cvt_pk_bf16(P[BASE + 6], P[BASE + 7]);                              \
    auto r0 = __builtin_amdgcn_permlane32_swap(a0, b0, false, false); auto r1 = __builtin_amdgcn_permlane32_swap(a1, b1, false, false); \
    u32x4 w = {r0[0], r1[0], r0[1], r1[1]}; OUT = __builtin_bit_cast(bf16x8, w); } while (0)
    PK4(p0, 0, pa0); PK4(p0, 8, pa1); PK4(p1, 0, pa2); PK4(p1, 8, pa3);
#undef PK4
}
template <int DK> __device__ __forceinline__ void qkt(f32x16& p0, f32x16& p1, const LAS char* Ks, const bf16x8* qr, int r32, int hi) {
#pragma unroll
    for (int r = 0; r < 16; ++r) { p0[r] = 0.f; p1[r] = 0.f; }
#pragma unroll
    for (int d0 = 0; d0 < Cfg<DK>::NK; ++d0) { const int cb = (d0 * 16 + hi * 8) * 2;
        const bf16x8 b0 = *(const LAS bf16x8*)(Ks + Cfg<DK>::kswz(r32, cb));
        const bf16x8 b1 = *(const LAS bf16x8*)(Ks + Cfg<DK>::kswz(32 + r32, cb));
        p0 = __builtin_amdgcn_mfma_f32_32x32x16_bf16(b0, qr[d0], p0, 0, 0, 0);
        p1 = __builtin_amdgcn_mfma_f32_32x32x16_bf16(b1, qr[d0], p1, 0, 0, 0); }
}
__device__ __forceinline__ int v_st(int k, int c) { const int kk = (k & ~0xC) | ((k & 4) << 1) | ((k & 8) >> 1); return ((kk >> 3) * 2 + (c >> 5)) * 512 + ((kk & 7) * 32 + (c & 31)) * 2; }
__device__ __forceinline__ int v_rd_base(int lane) { return ((lane & 3) << 3) | (((lane >> 2) & 3) << 6) | (((lane >> 4) & 1) << 5) | (((lane >> 5) & 1) << 8); }
constexpr int v_rd_off(int d0, int ks, int half) { return d0 * 512 + ks * 2048 + half * 1024; }
template <int OFF> __device__ __forceinline__ s16x4 tr_read(unsigned vb) {
    s16x4 r; asm volatile("ds_read_b64_tr_b16 %0, %1 offset:%2" : "=&v"(r) : "v"(vb), "i"(OFF) : "memory"); return r;
}
template <int D0> __device__ __forceinline__ void pv_one(f32x16& od, unsigned vb, bf16x8 pa0, bf16x8 pa1, bf16x8 pa2, bf16x8 pa3) {
    const s16x4 l0 = tr_read<v_rd_off(D0, 0, 0)>(vb), h0 = tr_read<v_rd_off(D0, 0, 1)>(vb), l1 = tr_read<v_rd_off(D0, 1, 0)>(vb), h1 = tr_read<v_rd_off(D0, 1, 1)>(vb);
    const s16x4 l2 = tr_read<v_rd_off(D0, 2, 0)>(vb), h2 = tr_read<v_rd_off(D0, 2, 1)>(vb), l3 = tr_read<v_rd_off(D0, 3, 0)>(vb), h3 = tr_read<v_rd_off(D0, 3, 1)>(vb);
    asm volatile("s_waitcnt lgkmcnt(0)" ::: "memory"); SBAR();
#define PK(L, H) (bf16x8){L[0], L[1], L[2], L[3], H[0], H[1], H[2], H[3]}
    od = __builtin_amdgcn_mfma_f32_32x32x16_bf16(pa0, PK(l0, h0), od, 0, 0, 0);
    od = __builtin_amdgcn_mfma_f32_32x32x16_bf16(pa1, PK(l1, h1), od, 0, 0, 0);
    od = __builtin_amdgcn_mfma_f32_32x32x16_bf16(pa2, PK(l2, h2), od, 0, 0, 0);
    od = __builtin_amdgcn_mfma_f32_32x32x16_bf16(pa3, PK(l3, h3), od, 0, 0, 0);
#undef PK
}
__device__ __forceinline__ void pv_d0(f32x16& o0, f32x16& o1, unsigned vb, bf16x8 pa0, bf16x8 pa1, bf16x8 pa2, bf16x8 pa3) {
    pv_one<0>(o0, vb, pa0, pa1, pa2, pa3); pv_one<1>(o1, vb, pa0, pa1, pa2, pa3);
}

template <int DK>
__device__ __forceinline__ void attn_unit(const bf16_t* __restrict__ Qb, int ldq, const bf16_t* __restrict__ Kh, int ldk, const bf16_t* __restrict__ Vh, int ldv,
                                          bf16_t* __restrict__ Ob, int ldo, int seq, LAS char* lds, const int tid) {
    using C = Cfg<DK>;
    constexpr int SHM_K = C::SHM_K, NK = C::NK;
    const int wid = tid >> 6, lane = tid & 63, r32 = lane & 31, hi = lane >> 5;
    LAS char* V_lds = lds; LAS char* K_lds = lds + 2 * SHM_V;
    LAS float* ws = (LAS float*)(lds + 2 * SHM_V + 2 * SHM_K) + wid * 64; LAS float* li_l = ws; LAS float* al_l = ws + 32;
    float m_reg = -1e30f, l_reg = 0.f; f32x16 o0, o1; bf16x8 qr[NK];
#pragma unroll
    for (int r = 0; r < 16; ++r) { o0[r] = 0.f; o1[r] = 0.f; }
    const bf16_t* Qw = Qb + (size_t)(wid * 32 + r32) * ldq + hi * 8;
#pragma unroll
    for (int d0 = 0; d0 < NK; ++d0) qr[d0] = *(const bf16x8*)(Qw + d0 * 16);
    const int vr = tid >> 3, vc = (tid & 7) * 8, vst = v_st(vr, vc);
    int kr0, kc0, kr1 = 0, kc1 = 0;
    if (DK == 64) { kr0 = tid >> 3; kc0 = tid & 7; } else { kr0 = tid / 12; kc0 = tid % 12; const int c1 = 512 + (tid & 255); kr1 = c1 / 12; kc1 = c1 % 12; }
    const int kst0 = C::kswz(kr0, kc0 * 16), kst1 = C::kswz(kr1, kc1 * 16);
    const bool k2 = (DK == 96) && (tid < 256);
    const unsigned vb0 = (unsigned)(uintptr_t)V_lds + (unsigned)v_rd_base(lane);
    bf16x8 sv0, sk0, sq0, sv1, sk1, sq1;
    sq0 = sq1 = (bf16x8){0, 0, 0, 0, 0, 0, 0, 0};
#define SLOAD(i, k0) do { sv##i = *(const bf16x8*)(Vh + (size_t)((k0) + vr) * ldv + vc); sk##i = *(const bf16x8*)(Kh + (size_t)((k0) + kr0) * ldk + kc0 * 8); \
        if (DK == 96) sq##i = *(const bf16x8*)(Kh + (size_t)((k0) + kr1) * ldk + kc1 * 8); } while (0)
#define SWRITE(b, i) do { *(LAS bf16x8*)(V_lds + (b) * SHM_V + vst) = sv##i; *(LAS bf16x8*)(K_lds + (b) * SHM_K + kst0) = sk##i; \
        if (k2) *(LAS bf16x8*)(K_lds + (b) * SHM_K + kst1) = sq##i; } while (0)
#define SWAIT() do { if (DK == 96) asm volatile("s_waitcnt vmcnt(3)" ::: "memory"); else asm volatile("s_waitcnt vmcnt(2)" ::: "memory"); } while (0)
#define RESC(a) do { if (__any((a) < 1.f)) { if (hi == 0) al_l[r32] = (a); asm volatile("s_waitcnt lgkmcnt(0)" ::: "memory"); \
        _Pragma("unroll") for (int r = 0; r < 16; ++r) { const float f = al_l[crow(r, hi)]; o0[r] *= f; o1[r] *= f; } } } while (0)
    f32x16 pA0, pA1, pB0, pB1; float mnA, mnB, alA, alB; bf16x8 pa0, pa1, pa2, pa3; const int NT = seq / 64;
    __syncthreads();
    SLOAD(0, 0); asm volatile("s_waitcnt vmcnt(0)" ::: "memory"); SWRITE(0, 0); __syncthreads();
    qkt<DK>(pA0, pA1, K_lds, qr, r32, hi); partialSM<DK>(pA0, pA1, m_reg, mnA, alA);
    SLOAD(1, 64); if (2 < NT) SLOAD(0, 128);
    SWAIT(); SWRITE(1, 1); __syncthreads();
    for (int j = 1; j + 1 < NT; j += 2) {
        SBAR(); qkt<DK>(pB0, pB1, K_lds + SHM_K, qr, r32, hi);
        finishSM(pA0, pA1, alA, l_reg, pa0, pa1, pa2, pa3); SBAR();
        SLOAD(1, (j + 2) * 64); SBAR();
        pv_d0(o0, o1, vb0, pa0, pa1, pa2, pa3); partialSM<DK>(pB0, pB1, m_reg, mnB, alB);
        __syncthreads(); SWAIT(); SWRITE(0, 0);
        RESC(alB); __syncthreads();
        SBAR(); qkt<DK>(pA0, pA1, K_lds, qr, r32, hi);
        finishSM(pB0, pB1, alB, l_reg, pa0, pa1, pa2, pa3); SBAR();
        if (j + 3 < NT) SLOAD(0, (j + 3) * 64); SBAR();
        pv_d0(o0, o1, vb0 + (unsigned)SHM_V, pa0, pa1, pa2, pa3); partialSM<DK>(pA0, pA1, m_reg, mnA, alA);
        __syncthreads(); SWAIT(); SWRITE(1, 1);
        RESC(alA); __syncthreads();
    }
    SBAR(); qkt<DK>(pB0, pB1, K_lds + SHM_K, qr, r32, hi);
    finishSM(pA0, pA1, alA, l_reg, pa0, pa1, pa2, pa3); SBAR();
    pv_d0(o0, o1, vb0, pa0, pa1, pa2, pa3); partialSM<DK>(pB0, pB1, m_reg, mnB, alB);
    __syncthreads(); RESC(alB);
    finishSM(pB0, pB1, alB, l_reg, pa0, pa1, pa2, pa3); SBAR();
    pv_d0(o0, o1, vb0 + (unsigned)SHM_V, pa0, pa1, pa2, pa3);
    if (hi == 0) li_l[r32] = l_reg;
    asm volatile("s_waitcnt lgkmcnt(0)" ::: "memory");
    bf16_t* Ow = Ob + (size_t)(wid * 32) * ldo;
#pragma unroll
    for (int r = 0; r < 16; ++r) { const int orow = crow(r, hi); const float rl = __builtin_amdgcn_rcpf(li_l[orow]);
        const unsigned w = cvt_pk_bf16(o0[r] * rl, o1[r] * rl);
        Ow[(size_t)orow * ldo + r32] = (bf16_t)(w & 0xffffu); Ow[(size_t)orow * ldo + 32 + r32] = (bf16_t)(w >> 16); }
#undef SLOAD
#undef SWRITE
#undef SWAIT
#undef RESC
}
}

struct Args { const float* in[18]; float* out; unsigned char* ws; int ph_lo, ph_hi; };

__device__ __forceinline__ int src_col(int mode, int p) {
    if (mode == 0) return p;
    if (mode == 1) {
        const int t = p >> 8, q = p & 255;
        if (t < 3) { const int bj = q >> 7, wc = (q >> 5) & 3, i = q & 31; return 256 * t + 64 * wc + 32 * bj + i; }
        if (t == 3) return 768 + q;
        if (t == 4) { if (q < 128) return 1024 + q; if (q < 160) { const int i = q - 128, n = i >> 4, ii = i & 15; return 1408 + ((ii < 8) ? ii : ii + 8) + 8 * n; } return -1; }
        if (t == 5) return 1152 + q;
        return 1440 + (p - 1536);
    }
    if (p < 512) return (p >> 6) * 96 + (p & 63);
    { const int q = p - 512, h = q >> 5, i = q & 31, n = i >> 4, ii = i & 15; return h * 96 + 64 + ((ii < 8) ? ii : ii + 8) + 8 * n; }
}
__device__ __forceinline__ void tr_item(const float* W, int K, int Nsrc, int nblk, bf16_t* WT, const float* gain, int mode, LAS float* scr, int item, int lane) {
    const int kb = item / nblk, nb = item % nblk, k0 = 64 * kb, n0 = 32 * nb;
    const int sc = src_col(mode, n0 + (lane & 31));
#pragma unroll 8
    for (int i = 0; i < 32; ++i) { const int kk = 2 * i + (lane >> 5); float v = (sc >= 0) ? W[(size_t)(k0 + kk) * Nsrc + sc] : 0.f; if (gain) v *= gain[k0 + kk]; scr[kk * 33 + (lane & 31)] = v; }
    asm volatile("s_waitcnt lgkmcnt(0)" ::: "memory");
    const int c = lane & 7;
#pragma unroll
    for (int j = 0; j < 4; ++j) { const int n = (lane >> 3) + 8 * j; const LAS float* s = scr + (8 * c) * 33 + n;
        u32x4 o; o.x = cvt_pk_bf16(s[0 * 33], s[1 * 33]); o.y = cvt_pk_bf16(s[2 * 33], s[3 * 33]); o.z = cvt_pk_bf16(s[4 * 33], s[5 * 33]); o.w = cvt_pk_bf16(s[6 * 33], s[7 * 33]);
        *(u32x4*)(WT + (size_t)(n0 + n) * K + k0 + 8 * c) = o; }
    asm volatile("s_waitcnt lgkmcnt(0)" ::: "memory");
}
__device__ __forceinline__ void prep_weights(const Args& a, unsigned char* wb, int l, LAS unsigned char* lds, int gw, int ngw, int wave, int lane) {
    LAS float* scr = (LAS float*)(lds + wave * 8704);
    constexpr int I_IN = 16 * (NIN / 32), I_Q = 6 * 24, I_KV = 4 * 32, I_A = 8 * 32, I_O = 16 * 32, I_UP = 16 * 128, I_DN = 64 * 32;
    constexpr int NITEMS = I_IN + I_Q + I_KV + 2 * I_A + I_O + I_UP + I_DN;
    for (int it = gw; it < NITEMS; it += ngw) {
        int r = it;
        if (r < I_IN) { tr_item(a.in[1] + (size_t)l * 1024 * INW, 1024, INW, NIN / 32, (bf16_t*)(wb + W_IN), a.in[14] + l * 1024, 1, scr, r, lane); continue; } r -= I_IN;
        if (r < I_Q) { tr_item(a.in[7] + (size_t)l * 384 * 768, 384, 768, 24, (bf16_t*)(wb + W_Q), a.in[5] + l * 384, 2, scr, r, lane); continue; } r -= I_Q;
        if (r < I_KV) { tr_item(a.in[8] + (size_t)l * 256 * 1024, 256, 1024, 32, (bf16_t*)(wb + W_KV), a.in[6] + l * 256, 0, scr, r, lane); continue; } r -= I_KV;
        if (r < I_A) { tr_item(a.in[9] + (size_t)l * 512 * 1024, 512, 1024, 32, (bf16_t*)(wb + W_A), nullptr, 0, scr, r, lane); continue; } r -= I_A;
        if (r < I_A) { tr_item(a.in[10] + (size_t)l * 512 * 1024, 512, 1024, 32, (bf16_t*)(wb + W_B), nullptr, 0, scr, r, lane); continue; } r -= I_A;
        if (r < I_O) { tr_item(a.in[11] + (size_t)l * 1024 * 1024, 1024, 1024, 32, (bf16_t*)(wb + W_O), nullptr, 0, scr, r, lane); continue; } r -= I_O;
        if (r < I_UP) { tr_item(a.in[12] + (size_t)l * 1024 * 4096, 1024, 4096, 128, (bf16_t*)(wb + W_UP), a.in[16] + l * 1024, 0, scr, r, lane); continue; } r -= I_UP;
        tr_item(a.in[13] + (size_t)l * 4096 * 1024, 4096, 1024, 32, (bf16_t*)(wb + W_DN), nullptr, 0, scr, r, lane);
    }
}
__device__ __forceinline__ void sincos_d(float ang, float& sn, float& cs) {
    const double x = (double)ang;
    const double kq = __builtin_rint(x * 0.63661977236758134308);
    const double r = (x - kq * 1.57079632679489655800) - kq * 6.12323399573676603587e-17;
    const double r2 = r * r;
    double s = -1.0 / 1307674368000.0;
    s = s * r2 + 1.0 / 6227020800.0; s = s * r2 - 1.0 / 39916800.0; s = s * r2 + 1.0 / 362880.0; s = s * r2 - 1.0 / 5040.0; s = s * r2 + 1.0 / 120.0; s = s * r2 - 1.0 / 6.0; s = s * r2 * r + r;
    double c = 1.0 / 20922789888000.0;
    c = c * r2 - 1.0 / 87178291200.0; c = c * r2 + 1.0 / 479001600.0; c = c * r2 - 1.0 / 3628800.0; c = c * r2 + 1.0 / 40320.0; c = c * r2 - 1.0 / 720.0; c = c * r2 + 1.0 / 24.0; c = c * r2 - 0.5; c = c * r2 + 1.0;
    const int q = ((int)kq) & 3;
    const double ss = (q == 0) ? s : (q == 1) ? c : (q == 2) ? -s : -c;
    const double cc = (q == 0) ? c : (q == 1) ? -s : (q == 2) ? -c : s;
    sn = (float)ss; cs = (float)cc;
}
__device__ __forceinline__ void resid_rows(const float* xin, const float* Mf, const float* slm, const float* gain, float* xout, bf16_t* Xb, float* rstdx, int gw, int ngw, int lane) {
    for (int row = gw; row < M; row += ngw) {
        float rm = 0.f;
        if (Mf) { const f32x4 sl = *(const f32x4*)(slm + row * 16 + 4 * (lane & 3)); float ss = (sl[0] + sl[1]) + (sl[2] + sl[3]); ss += __shfl_xor(ss, 1); ss += __shfl_xor(ss, 2); rm = rsqrtf(ss * (1.0f / 1024.0f) + EPS); }
        f32x4 xn[4]; float s2 = 0.f;
#pragma unroll
        for (int j = 0; j < 4; ++j) {
            const size_t idx = (size_t)row * 1024 + (64 * j + lane) * 4;
            f32x4 xv = *(const f32x4*)(xin + idx);
            if (Mf) { const f32x4 mv = *(const f32x4*)(Mf + idx), g = *(const f32x4*)(gain + (64 * j + lane) * 4); xv = xv + mv * rm * g; }
            xn[j] = xv; s2 += sumsq4(xv);
            if (xout) *(f32x4*)(xout + idx) = xv;
        }
        s2 = wave_sum(s2);
        if (lane == 0) rstdx[row] = rsqrtf(s2 * (1.0f / 1024.0f) + EPS);
#pragma unroll
        for (int j = 0; j < 4; ++j) st_bf4(Xb + (size_t)row * 1024 + (64 * j + lane) * 4, xn[j]);
    }
}

__global__ void __launch_bounds__(512) mk_fwd(Args a) {
    extern __shared__ __attribute__((aligned(16))) unsigned char lds_raw[];
    LAS unsigned char* lds = (LAS unsigned char*)lds_raw;
    cg::grid_group grid = cg::this_grid();
    int ph = a.ph_lo;
    if (ph == 0) {
    int tid = threadIdx.x; asm volatile("" : "+v"(tid));
    int bid = blockIdx.x; asm volatile("" : "+s"(bid));
    unsigned char* ws = a.ws; asm volatile("" : "+s"(ws));
    float* outp = a.out; asm volatile("" : "+s"(outp));
    const int lane = tid & 63, wave = __builtin_amdgcn_readfirstlane(tid >> 6);
    const int G = gridDim.x, gw = bid * 8 + wave, ngw = G * 8;
    float* rstdx = (float*)(ws + SM_RSTD); float* slq = (float*)(ws + SM_SLQ); float* slkv = (float*)(ws + SM_SLKV); float* slm = (float*)(ws + SM_SLM);
    float* tabA = (float*)(ws + SM_TABA); float* tabB = (float*)(ws + SM_TABB);
    unsigned char* wb = ws + WS_W;
    bf16_t* Xb = (bf16_t*)(ws + WS_XB); bf16_t* Y = (bf16_t*)(ws + WS_XB);
    bf16_t* Gt = (bf16_t*)(ws + WS_G); float* Mf = (float*)(ws + WS_G);
    unsigned char* rb = ws + WS_B;
    bf16_t *Qa = (bf16_t*)(rb + B_QA), *Ka = (bf16_t*)(rb + B_KA), *Va = (bf16_t*)(rb + B_VA), *Cq = (bf16_t*)(rb + B_CQ), *Ckv = (bf16_t*)(rb + B_CKV),
           *Qb = (bf16_t*)(rb + B_QB), *Kb = (bf16_t*)(rb + B_KB), *Vb = (bf16_t*)(rb + B_VB), *Mg = (bf16_t*)(rb + B_MG), *Hh = (bf16_t*)(rb + B_H);
    float* T = (float*)(rb + B_T);

            const int gt = bid * 512 + tid;
            if (gt < 2048) { const int pos = gt >> 4, f = gt & 15; double invd = 1.0; for (int i = 0; i < f; ++i) invd *= 0.56234132519034908; const float inv = (float)invd; float sn, cs; sincos_d((float)pos * inv, sn, cs); tabA[gt] = cs; tabA[2048 + gt] = sn; }
            else if (gt < 3072) { const int t = gt - 2048, pos = t >> 3, f = t & 7; double invd = 1.0; for (int i = 0; i < f; ++i) invd *= 0.31622776601683794; const float inv = (float)invd; float sn, cs; sincos_d((float)pos * inv, sn, cs); tabB[t] = cs; tabB[1024 + t] = sn; }
            prep_weights(a, wb, 0, lds, gw, ngw, wave, lane);
            resid_rows(a.in[0], nullptr, nullptr, nullptr, nullptr, Xb, rstdx, gw, ngw, lane);
        ph = 1;
        if (ph < a.ph_hi) grid.sync();
    }
    for (; ph < a.ph_hi; ++ph) {
    int tid = threadIdx.x; asm volatile("" : "+v"(tid));
    int bid = blockIdx.x; asm volatile("" : "+s"(bid));
    unsigned char* ws = a.ws; asm volatile("" : "+s"(ws));
    float* outp = a.out; asm volatile("" : "+s"(outp));
    const int lane = tid & 63, wave = __builtin_amdgcn_readfirstlane(tid >> 6);
    const int G = gridDim.x, gw = bid * 8 + wave, ngw = G * 8;
    float* rstdx = (float*)(ws + SM_RSTD); float* slq = (float*)(ws + SM_SLQ); float* slkv = (float*)(ws + SM_SLKV); float* slm = (float*)(ws + SM_SLM);
    float* tabA = (float*)(ws + SM_TABA); float* tabB = (float*)(ws + SM_TABB);
    unsigned char* wb = ws + WS_W;
    bf16_t* Xb = (bf16_t*)(ws + WS_XB); bf16_t* Y = (bf16_t*)(ws + WS_XB);
    bf16_t* Gt = (bf16_t*)(ws + WS_G); float* Mf = (float*)(ws + WS_G);
    unsigned char* rb = ws + WS_B;
    bf16_t *Qa = (bf16_t*)(rb + B_QA), *Ka = (bf16_t*)(rb + B_KA), *Va = (bf16_t*)(rb + B_VA), *Cq = (bf16_t*)(rb + B_CQ), *Ckv = (bf16_t*)(rb + B_CKV),
           *Qb = (bf16_t*)(rb + B_QB), *Kb = (bf16_t*)(rb + B_KB), *Vb = (bf16_t*)(rb + B_VB), *Mg = (bf16_t*)(rb + B_MG), *Hh = (bf16_t*)(rb + B_H);
    float* T = (float*)(rb + B_T);

        {
            const int l = (ph - 1) / 9, sp = (ph - 1) % 9;
            if (sp == 0 && (PH_MASK & 1)) {
                pg8::Gemm g{Xb, (const bf16_t*)(wb + W_IN), M, NIN, 1024, 1024, 1024}; pg8::StaticOrder S; S.init(M, NIN, G, bid);
                EpiIn E{rstdx, a.in[3] + l * 64, a.in[4] + l * 64, a.in[2] + l * 2048, tabA, tabB, Qa, Ka, Va, Cq, Ckv, Kb, Gt, slq, slkv};
                pg8::gemm_phase<EpiIn, true>(lds, g, S, E, tid);
            } else if (sp == 1 && (PH_MASK & 2)) {
                { pg8::Gemm g{Cq, (const bf16_t*)(wb + W_Q), M, 768, 384, 384, 384}; pg8::StaticOrder S; S.init(M, 768, G, bid);
                  EpiQup E{slq, tabB, Qb}; pg8::gemm_phase<EpiQup, false>(lds, g, S, E, tid); }
                { pg8::Gemm g{Ckv, (const bf16_t*)(wb + W_KV), M, 1024, 256, 256, 256}; pg8::StaticOrder S; S.init(M, 1024, G, (bid + 128) % G);
                  EpiKVup E{slkv, Kb, Vb}; pg8::gemm_phase<EpiKVup, false>(lds, g, S, E, tid); }
            } else if (sp == 2 && (PH_MASK & 4)) {
                for (int u = bid; u < 1024; u += G) {
                    int tid = threadIdx.x; asm volatile("" : "+v"(tid));
                    const int xcd = u & 7, qb = (u >> 3) & 31, combo = (u >> 8) * 8 + xcd;
                    if (combo < 16) { const int b = combo >> 3, h = combo & 7; const size_t r0 = (size_t)b * SEQ;
                        att::attn_unit<64>(Qa + (r0 + qb * 256) * 512 + h * 64, 512, Ka + r0 * 128 + (h >> 2) * 64, 128, Va + r0 * 128 + (h >> 2) * 64, 128,
                                           Y + (r0 + qb * 256) * 1024 + h * 64, 1024, SEQ, (LAS char*)lds, tid);
                    } else { const int c2 = combo - 16, b = c2 >> 3, h = c2 & 7; const size_t r0 = (size_t)b * SEQ;
                        att::attn_unit<96>(Qb + (r0 + qb * 256) * 768 + h * 96, 768, Kb + r0 * 768 + h * 96, 768, Vb + r0 * 512 + h * 64, 512,
                                           Y + (r0 + qb * 256) * 1024 + 512 + h * 64, 1024, SEQ, (LAS char*)lds, tid);
                    }
                }
            } else if (sp == 3 && (PH_MASK & 8)) {
                { pg8::Gemm g{Y, (const bf16_t*)(wb + W_A), M, 1024, 512, 1024, 512}; pg8::StaticOrder S; S.init(M, 1024, G, bid);
                  EpiBranch<0> E{Gt, T, Mg}; pg8::gemm_phase<EpiBranch<0>, false>(lds, g, S, E, tid); }
                { pg8::Gemm g{Y + 512, (const bf16_t*)(wb + W_B), M, 1024, 512, 1024, 512}; pg8::StaticOrder S; S.init(M, 1024, G, bid);
                  EpiBranch<1> E{Gt, T, Mg}; pg8::gemm_phase<EpiBranch<1>, false>(lds, g, S, E, tid); }
            } else if (sp == 4 && (PH_MASK & 16)) {
                pg8::Gemm g{Mg, (const bf16_t*)(wb + W_O), M, 1024, 1024, 1024, 1024}; pg8::StaticOrder S; S.init(M, 1024, G, bid);
                EpiF32Stats E{Mf, slm}; pg8::gemm_phase<EpiF32Stats, false>(lds, g, S, E, tid);
            } else if (sp == 5 && (PH_MASK & 32)) {
                resid_rows(l == 0 ? a.in[0] : outp, Mf, slm, a.in[15] + l * 1024, outp, Xb, rstdx, gw, ngw, lane);
            } else if (sp == 6 && (PH_MASK & 64)) {
                pg8::Gemm g{Xb, (const bf16_t*)(wb + W_UP), M, 4096, 1024, 1024, 1024}; pg8::StaticOrder S; S.init(M, 4096, G, bid);
                EpiUp E{rstdx, Hh}; pg8::gemm_phase<EpiUp, true>(lds, g, S, E, tid);
            } else if (sp == 7 && (PH_MASK & 128)) {
                pg8::Gemm g{Hh, (const bf16_t*)(wb + W_DN), M, 1024, 4096, 4096, 4096}; pg8::StaticOrder S; S.init(M, 1024, G, bid);
                EpiF32Stats E{Mf, slm}; pg8::gemm_phase<EpiF32Stats, false>(lds, g, S, E, tid);
            } else if (PH_MASK & 0x100) {
                resid_rows(outp, Mf, slm, a.in[17] + l * 1024, outp, Xb, rstdx, gw, ngw, lane);
                if (l + 1 < DEPTH) prep_weights(a, wb, l + 1, lds, gw, ngw, wave, lane);
            }
        }
        if (ph + 1 < a.ph_hi) grid.sync();
    }
}

constexpr int N_PHASES = 1 + 9 * DEPTH;

extern "C" void kernel_launch(void* const* d_in, const int* in_sizes, int n_in, void* d_out, int out_size, void* d_ws, size_t ws_size, hipStream_t stream) {
    static int grid = 0;
    if (grid == 0) {
        if (n_in != 18 || in_sizes[0] != M * DM || out_size != M * DM || ws_size < WS_END) { fprintf(stderr, "kernel_launch: unexpected shapes (n_in %d, in0 %d, out %d, ws %zu)\n", n_in, n_in > 0 ? in_sizes[0] : -1, out_size, ws_size); grid = -1; return; }
        int dev = 0, cus = 0, per_cu = 0;
        if (hipGetDevice(&dev) != hipSuccess || hipDeviceGetAttribute(&cus, hipDeviceAttributeMultiprocessorCount, dev) != hipSuccess) { grid = -1; return; }
        if (hipFuncSetAttribute((const void*)mk_fwd, hipFuncAttributeMaxDynamicSharedMemorySize, LDS_BYTES) != hipSuccess) { fprintf(stderr, "kernel_launch: hipFuncSetAttribute failed\n"); grid = -1; return; }
        if (hipOccupancyMaxActiveBlocksPerMultiprocessor(&per_cu, (const void*)mk_fwd, 512, LDS_BYTES) != hipSuccess || per_cu < 1) { fprintf(stderr, "kernel_launch: occupancy query gave %d\n", per_cu); per_cu = 1; }
        (void)hipGetLastError();
        grid = cus * per_cu;
        fprintf(stderr, "kernel_launch: grid %d (cus %d x %d), ws %zu\n", grid, cus, per_cu, ws_size);
    }
    if (grid < 0) return;
    Args a{};
    for (int i = 0; i < 18; ++i) a.in[i] = (const float*)d_in[i];
    a.out = (float*)d_out; a.ws = (unsigned char*)d_ws;
#if MK_ONE_LAUNCH
    a.ph_lo = 0; a.ph_hi = N_PHASES;
    void* args[] = {&a};
    hipError_t e = hipLaunchCooperativeKernel((const void*)mk_fwd, dim3(grid), dim3(512), args, LDS_BYTES, stream);
    if (e != hipSuccess) fprintf(stderr, "kernel_launch: cooperative launch failed: %s (grid %d)\n", hipGetErrorString(e), grid);
#else
    for (int ph = 0; ph < N_PHASES; ++ph) {
        a.ph_lo = ph; a.ph_hi = ph + 1;
        hipLaunchKernelGGL(mk_fwd, dim3(grid), dim3(512), LDS_BYTES, stream, a);
    }
#endif
}
```
